# Optimizing an MI355X kernel written in HIP

```python
import math
import jax, jax.numpy as jnp
from jax import lax
import numpy as np


D_MODEL = 1024
BATCH = 1
SEQ = 16384
DEPTH = 2
DEC_BATCH = 128
DEC_SEQ = 4
PAST_LEN = 16384
PAGE_SIZE = 128

N_MIXERS = 2
N_CONV_LAYERS = (DEPTH + 1) // 2
N_ATTN_LAYERS = DEPTH // 2
CONV_WIDTH = 3
CONV_STATE = CONV_WIDTH - 1
HEAD_DIM = 64
N_HEADS = D_MODEL // HEAD_DIM
N_KV_HEADS = 2
GROUP = N_HEADS // N_KV_HEADS
WINDOW = 128
BLOCK = WINDOW
N_BUCKETS = 32
MAX_DISTANCE = 128
D_FF = -(-8 * D_MODEL // (3 * 256)) * 256
EPS = 1e-5
NEG_INF = -1e30
ATTN_SCALE = 1.0 / math.sqrt(HEAD_DIM)

kernel_name = 'hybrid_shortconv_swa_sink_decoder_step'


def rms_norm(x, g):
    xf = x.astype(jnp.float32)
    y = xf * lax.rsqrt(jnp.mean(xf * xf, axis=-1, keepdims=True) + EPS)
    return (y * g.astype(jnp.float32)).astype(x.dtype)


def swiglu(x, w_gate, w_up, w_down):
    return (jax.nn.silu(x @ w_gate) * (x @ w_up)) @ w_down


def t5_bucket(dist):
    n = jnp.maximum(dist, 0)
    max_exact = N_BUCKETS // 2
    nf = jnp.maximum(n, 1).astype(jnp.float32)
    large = max_exact + (jnp.log(nf / max_exact) / math.log(MAX_DISTANCE / max_exact)
                         * (N_BUCKETS - max_exact)).astype(jnp.int32)
    large = jnp.minimum(large, N_BUCKETS - 1)
    return jnp.where(n < max_exact, n, large)


def rel_bias(dist, rel_table):
    b = rel_table[t5_bucket(dist)].astype(jnp.float32)
    return jnp.transpose(b, (2, 0, 1)).reshape(N_KV_HEADS, GROUP, dist.shape[0], dist.shape[1])


def sink_softmax(logits, sinks):
    s = jnp.broadcast_to(sinks.astype(jnp.float32).reshape(N_KV_HEADS, GROUP, 1, 1),
                         logits.shape[:-1] + (1,))
    p = jax.nn.softmax(jnp.concatenate([logits, s], axis=-1), axis=-1)
    return p[..., :-1]


def conv_mixer(h, prev, w_conv_in, conv_w, w_conv_out):
    T = h.shape[1]
    b, c, xi = jnp.split(h @ w_conv_in, 3, axis=-1)
    u = c * xi
    up = jnp.concatenate([prev.astype(u.dtype), u], axis=1)
    v = conv_w[0] * up[:, 0:T] + conv_w[1] * up[:, 1:T + 1] + conv_w[2] * up[:, 2:T + 2]
    y = (b * v) @ w_conv_out
    return y, up[:, -CONV_STATE:]


def swa_prompt(h, w_q, w_k, w_v, w_o, sinks, rel_table):
    N, S, _ = h.shape
    nb = S // BLOCK
    q = (h @ w_q).reshape(N, nb, BLOCK, N_KV_HEADS, GROUP, HEAD_DIM)
    k = (h @ w_k).reshape(N, S, N_KV_HEADS, HEAD_DIM)
    v = (h @ w_v).reshape(N, S, N_KV_HEADS, HEAD_DIM)
    pad = jnp.zeros((N, BLOCK, N_KV_HEADS, HEAD_DIM), k.dtype)
    kp = jnp.concatenate([pad, k], axis=1).reshape(N, nb + 1, BLOCK, N_KV_HEADS, HEAD_DIM)
    vp = jnp.concatenate([pad, v], axis=1).reshape(N, nb + 1, BLOCK, N_KV_HEADS, HEAD_DIM)
    kb = jnp.concatenate([kp[:, :-1], kp[:, 1:]], axis=2)
    vb = jnp.concatenate([vp[:, :-1], vp[:, 1:]], axis=2)
    qi = jnp.arange(BLOCK)[:, None] + BLOCK
    kj = jnp.arange(2 * BLOCK)[None, :]
    dist = qi - kj
    band = (dist >= 0) & (dist <= WINDOW)
    blk = jnp.arange(nb)[:, None, None]
    valid = band[None] & ((blk > 0) | (kj >= BLOCK)[None])
    bias = rel_bias(dist, rel_table)
    logits = jnp.einsum('nbqkgd,nbskd->nbkgqs', q, kb,
                        preferred_element_type=jnp.float32) * ATTN_SCALE + bias
    logits = jnp.where(valid[None, :, None, None], logits, NEG_INF)
    p = sink_softmax(logits, sinks)
    o = jnp.einsum('nbkgqs,nbskd->nbqkgd', p.astype(vb.dtype), vb)
    y = o.reshape(N, S, D_MODEL) @ w_o
    return y, k[:, -WINDOW:], v[:, -WINDOW:]


def swa_sample(h, k_prev, v_prev, w_q, w_k, w_v, w_o, sinks, rel_table):
    N, T, _ = h.shape
    q = (h @ w_q).reshape(N, T, N_KV_HEADS, GROUP, HEAD_DIM)
    k_new = (h @ w_k).reshape(N, T, N_KV_HEADS, HEAD_DIM)
    v_new = (h @ w_v).reshape(N, T, N_KV_HEADS, HEAD_DIM)
    kc = jnp.concatenate([k_prev.astype(k_new.dtype), k_new], axis=1)
    vc = jnp.concatenate([v_prev.astype(v_new.dtype), v_new], axis=1)
    dist = jnp.arange(T)[:, None] - (jnp.arange(WINDOW + T)[None, :] - WINDOW)
    valid = (dist >= 0) & (dist <= WINDOW)
    bias = rel_bias(dist, rel_table)
    logits = jnp.einsum('nqkgd,nskd->nkgqs', q, kc,
                        preferred_element_type=jnp.float32) * ATTN_SCALE + bias
    logits = jnp.where(valid, logits, NEG_INF)
    p = sink_softmax(logits, sinks)
    o = jnp.einsum('nkgqs,nskd->nqkgd', p.astype(vc.dtype), vc)
    y = o.reshape(N, T, D_MODEL) @ w_o
    return y, kc[:, -WINDOW:], vc[:, -WINDOW:]


def trunk(x, conv_prev, k_prev, v_prev, g_mix, g_ffn, g_final, w_conv_in, conv_w, w_conv_out,
          w_q, w_k, w_v, w_o, sinks, rel_table, w_gate, w_up, w_down):
    conv_states, k_states, v_states = [], [], []
    for i in range(DEPTH):
        j = i // N_MIXERS
        h = rms_norm(x, g_mix[i])
        if i % N_MIXERS == 0:
            y, st = conv_mixer(h, conv_prev[j], w_conv_in[j], conv_w[j], w_conv_out[j])
            conv_states.append(st)
        else:
            if k_prev is None:
                y, ks, vs = swa_prompt(h, w_q[j], w_k[j], w_v[j], w_o[j], sinks[j], rel_table)
            else:
                y, ks, vs = swa_sample(h, k_prev[j], v_prev[j], w_q[j], w_k[j], w_v[j], w_o[j],
                                       sinks[j], rel_table)
            k_states.append(ks)
            v_states.append(vs)
        x = x + y
        x = x + swiglu(rms_norm(x, g_ffn[i]), w_gate[i], w_up[i], w_down[i])
    return rms_norm(x, g_final), jnp.stack(conv_states), jnp.stack(k_states), jnp.stack(v_states)


def setup_inputs(seed: int = 0) -> dict:
    key = jax.random.key(seed)
    ks = jax.random.split(key, 24)
    nrm = lambda k, shape, s: jax.random.normal(k, shape, jnp.float32) * s
    D = D_MODEL
    return {
        'x_prompt': nrm(ks[0], (BATCH, SEQ, D), 1.0),
        'x_sample': nrm(ks[1], (DEC_BATCH, DEC_SEQ, D), 1.0),
        'state_conv': nrm(ks[2], (N_CONV_LAYERS, DEC_BATCH, CONV_STATE, D), 1.0),
        'cache_k': nrm(ks[3], (N_ATTN_LAYERS, DEC_BATCH, WINDOW, N_KV_HEADS, HEAD_DIM), 1.0),
        'cache_v': nrm(ks[4], (N_ATTN_LAYERS, DEC_BATCH, WINDOW, N_KV_HEADS, HEAD_DIM), 1.0),
        'g_mix': 1.0 + nrm(ks[5], (DEPTH, D), 0.05),
        'g_ffn': 1.0 + nrm(ks[6], (DEPTH, D), 0.05),
        'g_final': 1.0 + nrm(ks[7], (D,), 0.05),
        'w_conv_in': nrm(ks[8], (N_CONV_LAYERS, D, 3 * D), D ** -0.5),
        'conv_w': nrm(ks[9], (N_CONV_LAYERS, CONV_WIDTH, D), CONV_WIDTH ** -0.5),
        'w_conv_out': nrm(ks[10], (N_CONV_LAYERS, D, D), D ** -0.5),
        'w_q': nrm(ks[11], (N_ATTN_LAYERS, D, N_HEADS * HEAD_DIM), D ** -0.5),
        'w_k': nrm(ks[12], (N_ATTN_LAYERS, D, N_KV_HEADS * HEAD_DIM), D ** -0.5),
        'w_v': nrm(ks[13], (N_ATTN_LAYERS, D, N_KV_HEADS * HEAD_DIM), D ** -0.5),
        'w_o': nrm(ks[14], (N_ATTN_LAYERS, N_HEADS * HEAD_DIM, D), (N_HEADS * HEAD_DIM) ** -0.5),
        'sinks': nrm(ks[15], (N_ATTN_LAYERS, N_HEADS), 0.5),
        'rel_table': nrm(ks[16], (N_BUCKETS, N_HEADS), 0.5),
        'w_gate': nrm(ks[17], (DEPTH, D, D_FF), D ** -0.5),
        'w_up': nrm(ks[18], (DEPTH, D, D_FF), D ** -0.5),
        'w_down': nrm(ks[19], (DEPTH, D_FF, D), D_FF ** -0.5),
    }


def reference(x_prompt, x_sample, state_conv, cache_k, cache_v, g_mix, g_ffn, g_final,
              w_conv_in, conv_w, w_conv_out, w_q, w_k, w_v, w_o, sinks, rel_table,
              w_gate, w_up, w_down):
    zero_prev = jnp.zeros((N_CONV_LAYERS, x_prompt.shape[0], CONV_STATE, D_MODEL), x_prompt.dtype)
    y_prompt, state_conv_prompt, cache_k_prompt, cache_v_prompt = trunk(
        x_prompt, zero_prev, None, None, g_mix, g_ffn, g_final, w_conv_in, conv_w, w_conv_out,
        w_q, w_k, w_v, w_o, sinks, rel_table, w_gate, w_up, w_down)
    y_sample, state_conv_sample, cache_k_sample, cache_v_sample = trunk(
        x_sample, state_conv, cache_k, cache_v, g_mix, g_ffn, g_final, w_conv_in, conv_w, w_conv_out,
        w_q, w_k, w_v, w_o, sinks, rel_table, w_gate, w_up, w_down)
    return (y_prompt, y_sample, state_conv_prompt, state_conv_sample,
            cache_k_prompt, cache_k_sample, cache_v_prompt, cache_v_sample)
```

```cpp
#include <hip/hip_runtime.h>
#include <cstdio>
#include <cstdint>

#ifndef MK_N_LAUNCHES
#define MK_N_LAUNCHES 12
#endif

#define LAS __attribute__((address_space(3)))
#define GAS __attribute__((address_space(1)))

constexpr int D = 1024, SEQ = 16384, NSEQ = 128, TS = 4, MS = NSEQ * TS, M = SEQ + MS;
constexpr int DFF = 2816, NQKV = 1280, NCI = 3072, WIN = 128, HD = 64, NH = 16;
constexpr float EPS = 1e-5f, LOG2E = 1.4426950408889634f, QSCALE = 0.125f * LOG2E;
constexpr float NEGBIG = -1e30f;

constexpr size_t O_Y = 0, O_SCP = (size_t)M * D, O_SCS = O_SCP + 2 * D, O_CKP = O_SCS + (size_t)NSEQ * 2 * D, O_CKS = O_CKP + 128 * 128,
                 O_CVP = O_CKS + (size_t)NSEQ * 128 * 128, O_CVS = O_CVP + 128 * 128;

constexpr size_t MiB = 1u << 20;
constexpr size_t WS_CTL = 0, CTL_ZERO_BYTES = 64 * 1024;
constexpr size_t WS_PART = 1 * MiB;
constexpr size_t PART_STRIDE = (size_t)M * 16;
constexpr size_t WS_W1 = 8 * MiB, WS_W2 = 14 * MiB, WS_W3 = 16 * MiB, WS_W4 = 27 * MiB, WS_W5 = 33 * MiB, WS_W6 = 36 * MiB, WS_W7 = 38 * MiB, WS_W8 = 49 * MiB;
constexpr size_t WS_XB = 55 * MiB, WS_U = 88 * MiB, WS_BQ = 121 * MiB, WS_K = 154 * MiB, WS_V = 159 * MiB, WS_A = 164 * MiB, WS_END = 256 * MiB;
static_assert(WS_A + (size_t)M * DFF * 2 <= WS_END, "ws map");
static_assert(WS_W8 + (size_t)D * DFF * 2 <= WS_XB && WS_W4 + (size_t)D * DFF * 2 <= WS_W5 && WS_W3 + (size_t)2 * DFF * D * 2 <= WS_W4, "ws map (weights)");

namespace pg8 {
typedef unsigned short bf16_t;
typedef short bf16x8 __attribute__((ext_vector_type(8)));
typedef float f32x4 __attribute__((ext_vector_type(4)));
typedef unsigned u32x4 __attribute__((ext_vector_type(4)));
constexpr int BM = 256, BK = 64, HALF = 128, HTB = HALF * BK * 2, STAGE_BYTES = 8 * HTB, NXCD = 8, WGM = 8;

__host__ __device__ __forceinline__ int lds_byte(int r, int c) { const int st = (r >> 4) * 2 + (c >> 5), rr = r & 15, cc = c & 31, ob = rr * 64 + cc * 2; return st * 1024 + (ob ^ (((ob >> 9) & 1) << 5)); }
__host__ __device__ __forceinline__ void stage_rc(int b, int& R, int& C) { const int st = b / 1024, sb = b % 1024, swz = sb ^ (((sb >> 9) & 1) << 5); R = (st >> 1) * 16 + swz / 64; C = (st & 1) * 32 + (swz % 64) / 2; }
__host__ __device__ __forceinline__ int perm32(int rho) { const int n = rho >> 4, i = rho & 15; return 8 * (i >> 2) + 4 * n + (i & 3); }

struct Unit { int pm, pn; };
struct Gemm { const bf16_t* A; const bf16_t* Bt; int M, N, K; };

struct StaticOrder {
    int nM, nN, nwg, G, c;
    __host__ __device__ void init(int M_, int N_, int G_, int c_) { nM = M_ / BM; nN = N_ / BM; nwg = nM * nN; G = G_; c = c_; }
    __host__ __device__ bool next(int i, Unit& u) const {
        const long L = (long)i * G + c; if (L >= nwg) return false;
        int wgid = (int)L; { const int q = nwg / NXCD, r = nwg % NXCD, xcd = wgid % NXCD, off = wgid / NXCD; wgid = (xcd < r ? xcd * (q + 1) : r * (q + 1) + (xcd - r) * q) + off; }
        const int nig = WGM * nN, gid = wgid / nig, fm = gid * WGM, gsz = (nM - fm) < WGM ? (nM - fm) : WGM;
        u.pm = fm + ((wgid % nig) % gsz); u.pn = (wgid % nig) / gsz; return true;
    }
    __device__ __forceinline__ void a_ready(const Unit&) const {}
    __device__ __forceinline__ void done(const Unit&) const {}
};

__device__ __forceinline__ unsigned cvt_pk_bf16(float lo, float hi) { unsigned r; asm volatile("v_cvt_pk_bf16_f32 %0, %1, %2" : "=v"(r) : "v"(lo), "v"(hi)); return r; }

template <class Epi, class Sched, bool ALIGN_EPI = true>
__device__ __forceinline__ void gemm_phase(LAS unsigned char* lds, const Gemm g, const Sched& S, const Epi& E) {
    const int tid = threadIdx.x, wid = __builtin_amdgcn_readfirstlane(tid >> 6), lane = tid & 63, wr = wid >> 2, wc = wid & 3, fr = lane & 15, fq = lane >> 4;
    const int K = g.K, nt = K / BK;
    unsigned voffA[2], voffB[2];
#pragma unroll
    for (int i = 0; i < 2; ++i) { int R, C; stage_rc(tid * 16 + i * 8192, R, C); const int Rb = Epi::PERM ? ((R & ~31) + perm32(R & 31)) : R;
        voffA[i] = (unsigned)(R * K + C) * 2u; voffB[i] = (unsigned)(Rb * K + C) * 2u; }
    const size_t kstep = (size_t)(BK * 2);
    const size_t hstep = (size_t)HALF * K * 2;
    const size_t tstep = 2 * hstep;
    const unsigned ldsw = (unsigned)wid * 1024u;
    const int aoff = lds_byte(wr * 64 + fr, fq * 8), boff = lds_byte(wc * 32 + fr, fq * 8);
#define PG8_SA(b, h) (((b) * 2 + (h)) * HTB)
#define PG8_SB(b, h) ((4 + (b) * 2 + (h)) * HTB)
#define PG8_STAGE(bufoff, gbase, voff) do { _Pragma("unroll") for (int _i = 0; _i < 2; ++_i) \
        __builtin_amdgcn_global_load_lds((const unsigned*)((const char*)(gbase) + (voff)[_i]), (LAS unsigned*)(lds + (bufoff) + ldsw + _i * 8192), 16, 0, 0); } while (0)
#define PG8_LDA(dst, b, h) do { _Pragma("unroll") for (int m = 0; m < 4; ++m) _Pragma("unroll") for (int k = 0; k < 2; ++k) dst[m][k] = *(const LAS bf16x8*)(lds + PG8_SA(b, h) + aoff + m * 2048 + k * 1024); } while (0)
#define PG8_LDB(dst, b, h) do { _Pragma("unroll") for (int n = 0; n < 2; ++n) _Pragma("unroll") for (int k = 0; k < 2; ++k) dst[n][k] = *(const LAS bf16x8*)(lds + PG8_SB(b, h) + boff + n * 2048 + k * 1024); } while (0)
#define PG8_MMA(ai, bj, At, Bt) do { __builtin_amdgcn_s_setprio(1); _Pragma("unroll") for (int m = 0; m < 4; ++m) _Pragma("unroll") for (int n = 0; n < 2; ++n) _Pragma("unroll") for (int k = 0; k < 2; ++k) \
        acc[ai][bj][m][n] = __builtin_amdgcn_mfma_f32_16x16x32_bf16(Bt[n][k], At[m][k], acc[ai][bj][m][n], 0, 0, 0); __builtin_amdgcn_s_setprio(0); } while (0)
#define PG8_WAIT_V(n) asm volatile("s_waitcnt vmcnt(" #n ")" ::: "memory")
#define PG8_WAIT_L(n) asm volatile("s_waitcnt lgkmcnt(" #n ")" ::: "memory")
#define PG8_BAR __builtin_amdgcn_s_barrier()
#define PG8_SCHED __builtin_amdgcn_sched_barrier(0)
    Unit cur, nxt; int ui = 0;
    if (!S.next(0, cur)) return;
    f32x4 acc[2][2][4][2];
#pragma unroll
    for (int a = 0; a < 2; ++a)
#pragma unroll
        for (int b = 0; b < 2; ++b)
#pragma unroll
            for (int m = 0; m < 4; ++m)
#pragma unroll
                for (int n = 0; n < 2; ++n) acc[a][b][m][n] = (f32x4){0.f, 0.f, 0.f, 0.f};
    bf16x8 At[4][2], B0[2][2], B1[2][2];
    const char* cA = (const char*)g.A + (size_t)cur.pm * tstep; const char* cB = (const char*)g.Bt + (size_t)cur.pn * tstep;
    S.a_ready(cur);
    PG8_STAGE(PG8_SB(0, 0), cB, voffB); PG8_STAGE(PG8_SB(0, 1), cB + hstep, voffB); PG8_STAGE(PG8_SA(0, 0), cA, voffA); PG8_STAGE(PG8_SA(0, 1), cA + hstep, voffA);
    if (wr == 1) PG8_BAR;
    PG8_WAIT_V(2); PG8_BAR;
    PG8_STAGE(PG8_SB(1, 0), cB + kstep, voffB); PG8_STAGE(PG8_SA(1, 0), cA + kstep, voffA); PG8_STAGE(PG8_SB(1, 1), cB + hstep + kstep, voffB);
    PG8_WAIT_V(6); PG8_BAR;
    for (;;) {
        const bool has_next = S.next(ui + 1, nxt);
        const char* nA = has_next ? (const char*)g.A + (size_t)nxt.pm * tstep : cA; const char* nB = has_next ? (const char*)g.Bt + (size_t)nxt.pn * tstep : cB;
        for (int t = 0; t < nt; t += 2) {
            const bool last = (t == nt - 2);
            const char* a1 = cA + (size_t)(t + 1) * kstep;
            const char* a2 = last ? nA : cA + (size_t)(t + 2) * kstep; const char* b2 = last ? nB : cB + (size_t)(t + 2) * kstep;
            const char* a3 = a2 + kstep; const char* b3 = b2 + kstep;
            if (last && has_next) S.a_ready(nxt);
            PG8_LDB(B0, 0, 0); PG8_LDB(B1, 0, 1); PG8_SCHED; PG8_LDA(At, 0, 0); PG8_STAGE(PG8_SA(1, 1), a1 + hstep, voffA);
            PG8_WAIT_V(8); PG8_WAIT_L(0); PG8_BAR; PG8_MMA(0, 0, At, B0); PG8_MMA(0, 1, At, B1); PG8_BAR; PG8_SCHED;
            PG8_LDA(At, 0, 1); PG8_STAGE(PG8_SB(0, 0), b2, voffB); PG8_STAGE(PG8_SB(0, 1), b2 + hstep, voffB); PG8_STAGE(PG8_SA(0, 0), a2, voffA);
            PG8_WAIT_V(8); PG8_WAIT_L(0); PG8_BAR; PG8_MMA(1, 0, At, B0); PG8_MMA(1, 1, At, B1); PG8_BAR; PG8_SCHED;
            PG8_LDB(B0, 1, 0); PG8_LDB(B1, 1, 1); PG8_SCHED; PG8_LDA(At, 1, 0); PG8_STAGE(PG8_SA(0, 1), a2 + hstep, voffA);
            PG8_WAIT_V(8); PG8_WAIT_L(0); PG8_BAR; PG8_MMA(0, 0, At, B0); PG8_MMA(0, 1, At, B1); PG8_BAR; PG8_SCHED;
            PG8_LDA(At, 1, 1); PG8_STAGE(PG8_SB(1, 0), b3, voffB); PG8_STAGE(PG8_SB(1, 1), b3 + hstep, voffB); PG8_STAGE(PG8_SA(1, 0), a3, voffA);
            PG8_WAIT_V(8); PG8_WAIT_L(0); PG8_BAR; PG8_MMA(1, 0, At, B0); PG8_MMA(1, 1, At, B1); PG8_BAR; PG8_SCHED;
        }
        if constexpr (ALIGN_EPI) { if (wr == 0) PG8_BAR; }
        E(acc, cur, wr, wc, fr, fq); S.done(cur);
        if (!has_next) break;
#pragma unroll
        for (int a = 0; a < 2; ++a)
#pragma unroll
            for (int b = 0; b < 2; ++b)
#pragma unroll
                for (int m = 0; m < 4; ++m)
#pragma unroll
                    for (int n = 0; n < 2; ++n) acc[a][b][m][n] = (f32x4){0.f, 0.f, 0.f, 0.f};
        cur = nxt; cA = nA; cB = nB; ++ui;
        if constexpr (ALIGN_EPI) { if (wr == 1) PG8_BAR; }
    }
    PG8_WAIT_V(0);
    if constexpr (!ALIGN_EPI) { if (wr == 0) PG8_BAR; }
    PG8_BAR;
#undef PG8_SA
#undef PG8_SB
#undef PG8_STAGE
#undef PG8_LDA
#undef PG8_LDB
#undef PG8_MMA
#undef PG8_WAIT_V
#undef PG8_WAIT_L
#undef PG8_BAR
#undef PG8_SCHED
}
}

using pg8::bf16_t; using pg8::f32x4; using pg8::u32x4; using pg8::bf16x8; using pg8::Unit; using pg8::cvt_pk_bf16;
typedef float f32x16 __attribute__((ext_vector_type(16)));
typedef short s16x4 __attribute__((ext_vector_type(4)));

__device__ __forceinline__ float row_rstd(const float* part, int row, int fq) {
    const f32x4 p = *(const f32x4*)(part + (size_t)row * 16 + fq * 4);
    float s = (p[0] + p[1]) + (p[2] + p[3]);
    s += __shfl_xor(s, 16); s += __shfl_xor(s, 32);
    return __builtin_amdgcn_rsqf(s * (1.0f / D) + EPS);
}
__device__ __forceinline__ u32x4 pack8(const f32x4 a, const f32x4 b) { u32x4 w; w.x = cvt_pk_bf16(a[0], a[1]); w.y = cvt_pk_bf16(a[2], a[3]); w.z = cvt_pk_bf16(b[0], b[1]); w.w = cvt_pk_bf16(b[2], b[3]); return w; }

struct EpiConvIn {
    static constexpr bool PERM = true;
    const float* part; bf16_t* U; bf16_t* Bb;
    __device__ __forceinline__ void operator()(const f32x4 (&acc)[2][2][4][2], const Unit& u, int wr, int wc, int fr, int fq) const {
#pragma unroll
        for (int ai = 0; ai < 2; ++ai)
#pragma unroll
            for (int m = 0; m < 4; ++m) {
                const int row = u.pm * 256 + ai * 128 + wr * 64 + m * 16 + fr;
                const float r = row_rstd(part, row, fq);
                if (u.pn < 8) {
                    const float r2 = r * r;
                    const f32x4 v0 = acc[ai][0][m][0] * acc[ai][1][m][0] * r2, v1 = acc[ai][0][m][1] * acc[ai][1][m][1] * r2;
                    *(u32x4*)(U + (size_t)row * D + u.pn * 128 + wc * 32 + fq * 8) = pack8(v0, v1);
                } else {
#pragma unroll
                    for (int bj = 0; bj < 2; ++bj)
                        *(u32x4*)(Bb + (size_t)row * D + (u.pn - 8) * 256 + bj * 128 + wc * 32 + fq * 8) = pack8(acc[ai][bj][m][0] * r, acc[ai][bj][m][1] * r);
                }
            }
    }
};
struct EpiResid {
    static constexpr bool PERM = true;
    const float* xsrc_p; const float* xsrc_s; float* xdst; bf16_t* XB; float* part;
    __device__ __forceinline__ void operator()(const f32x4 (&acc)[2][2][4][2], const Unit& u, int wr, int wc, int fr, int fq) const {
#pragma unroll
        for (int ai = 0; ai < 2; ++ai)
#pragma unroll
            for (int m = 0; m < 4; ++m) {
                const int row = u.pm * 256 + ai * 128 + wr * 64 + m * 16 + fr;
                const float* xs = (row < SEQ ? xsrc_p : xsrc_s) + (size_t)row * D;
                float ss = 0.f;
#pragma unroll
                for (int bj = 0; bj < 2; ++bj) {
                    const int col = u.pn * 256 + bj * 128 + wc * 32 + fq * 8;
                    const f32x4 x0 = *(const f32x4*)(xs + col) + acc[ai][bj][m][0], x1 = *(const f32x4*)(xs + col + 4) + acc[ai][bj][m][1];
                    *(f32x4*)(xdst + (size_t)row * D + col) = x0; *(f32x4*)(xdst + (size_t)row * D + col + 4) = x1;
                    *(u32x4*)(XB + (size_t)row * D + col) = pack8(x0, x1);
                    ss += (x0[0] * x0[0] + x0[1] * x0[1]) + (x0[2] * x0[2] + x0[3] * x0[3]) + (x1[0] * x1[0] + x1[1] * x1[1]) + (x1[2] * x1[2] + x1[3] * x1[3]);
                }
                ss += __shfl_xor(ss, 16); ss += __shfl_xor(ss, 32);
                if (fq == 0) part[(size_t)row * 16 + u.pn * 4 + wc] = ss;
                if (m & 1) asm volatile("" ::: "memory");
            }
    }
};
struct EpiSwiglu {
    static constexpr bool PERM = true;
    const float* part; bf16_t* Ab;
    __device__ __forceinline__ void operator()(const f32x4 (&acc)[2][2][4][2], const Unit& u, int wr, int wc, int fr, int fq) const {
#pragma unroll
        for (int ai = 0; ai < 2; ++ai)
#pragma unroll
            for (int m = 0; m < 4; ++m) {
                const int row = u.pm * 256 + ai * 128 + wr * 64 + m * 16 + fr;
                const float r = row_rstd(part, row, fq);
                f32x4 o[2];
#pragma unroll
                for (int n = 0; n < 2; ++n) {
                    const f32x4 g = acc[ai][0][m][n] * r, up = acc[ai][1][m][n] * r;
#pragma unroll
                    for (int j = 0; j < 4; ++j) { const float e = __builtin_amdgcn_exp2f(-g[j] * LOG2E); o[n][j] = g[j] * __builtin_amdgcn_rcpf(1.0f + e) * up[j]; }
                }
                *(u32x4*)(Ab + (size_t)row * DFF + u.pn * 128 + wc * 32 + fq * 8) = pack8(o[0], o[1]);
            }
    }
};
struct EpiQKV {
    static constexpr bool PERM = true;
    const float* part; bf16_t* Q; bf16_t* Kb; bf16_t* Vb; float* out;
    __device__ __forceinline__ void operator()(const f32x4 (&acc)[2][2][4][2], const Unit& u, int wr, int wc, int fr, int fq) const {
#pragma unroll
        for (int ai = 0; ai < 2; ++ai)
#pragma unroll
            for (int m = 0; m < 4; ++m) {
                const int row = u.pm * 256 + ai * 128 + wr * 64 + m * 16 + fr;
                const float r = row_rstd(part, row, fq);
                if (u.pn < 4) {
                    const float rq = r * QSCALE;
#pragma unroll
                    for (int bj = 0; bj < 2; ++bj)
                        *(u32x4*)(Q + (size_t)row * D + u.pn * 256 + bj * 128 + wc * 32 + fq * 8) = pack8(acc[ai][bj][m][0] * rq, acc[ai][bj][m][1] * rq);
                } else {
                    const int col = wc * 32 + fq * 8;
#pragma unroll
                    for (int bj = 0; bj < 2; ++bj) {
                        const f32x4 v0 = acc[ai][bj][m][0] * r, v1 = acc[ai][bj][m][1] * r;
                        *(u32x4*)((bj ? Vb : Kb) + (size_t)row * 128 + col) = pack8(v0, v1);
                        float* o = nullptr;
                        if (row >= SEQ) { const int n = (row - SEQ) >> 2, t = (row - SEQ) & 3; o = out + (bj ? O_CVS : O_CKS) + ((size_t)n * 128 + 124 + t) * 128 + col; }
                        else if (row >= SEQ - WIN) o = out + (bj ? O_CVP : O_CKP) + (size_t)(row - (SEQ - WIN)) * 128 + col;
                        if (o) { *(f32x4*)o = v0; *(f32x4*)(o + 4) = v1; }
                    }
                }
            }
    }
};

typedef GAS unsigned gu32;
#define RLX_AGENT __ATOMIC_RELAXED, __HIP_MEMORY_SCOPE_AGENT
#define XB_TMO      128
#define XB_XCNT(j)  (256  + 64 * (j))
#define XB_XSUB(j)  (1280 + 64 * (j))
#define XB_XGEN(j)  (2304 + 64 * (j))
#define XB_TOP      3328
#define XB_TOPGEN   3392
#define XCD_BAR_WORDS 3456
#define XB_SPIN_CAP (1u << 20)
__device__ __forceinline__ unsigned xb_ld(unsigned* p)              { return __hip_atomic_load(p, __ATOMIC_RELAXED, __HIP_MEMORY_SCOPE_AGENT); }
__device__ __forceinline__ unsigned xb_add(unsigned* p, unsigned v) { return __hip_atomic_fetch_add(p, v, __ATOMIC_RELAXED, __HIP_MEMORY_SCOPE_AGENT); }
__device__ __forceinline__ unsigned xb_xcc_id() { return (unsigned)__builtin_amdgcn_s_getreg((3 << 11) | 20) & 0xFu; }
#define XB_SPIN(cond, bar) do { unsigned _sp = 0; while (cond) { __builtin_amdgcn_s_sleep(1); \
    if ((++_sp & 255u) == 0u) { if (xb_ld(&(bar)[XB_TMO])) break; if (_sp > XB_SPIN_CAP) { atomicAdd(&(bar)[XB_TMO], 1u); break; } } } } while (0)
struct XcdBarrier { unsigned* bar; unsigned x; volatile LAS unsigned* st; };
__device__ __forceinline__ XcdBarrier xcd_barrier_post(unsigned* bar, volatile LAS unsigned* st) {
    XcdBarrier b; b.bar = bar; b.x = xb_xcc_id(); b.st = st;
    if (threadIdx.x == 0) (void)xb_add(&bar[XB_XCNT(b.x)], 1u);
    return b;
}
__device__ __forceinline__ void xcd_barrier_complete(unsigned* bar, unsigned x, unsigned& nloc, unsigned& nx) {
    const unsigned G = gridDim.x * gridDim.y * gridDim.z;
    unsigned sum, cnt, mine, sp = 0u;
    for (;;) {
        sum = 0u; cnt = 0u; mine = 0u;
#pragma unroll
        for (unsigned j = 0; j < 16; ++j) { const unsigned c = xb_ld(&bar[XB_XCNT(j)]); sum += c; cnt += (c > 0u) ? 1u : 0u; mine = (j == x) ? c : mine; }
        if (sum == G) break;
        __builtin_amdgcn_s_sleep(1);
        if ((++sp & 255u) == 0u) { if (xb_ld(&bar[XB_TMO])) break; if (sp > XB_SPIN_CAP) { atomicAdd(&bar[XB_TMO], 1u); break; } }
    }
    nloc = mine > 0u ? mine : 1u; nx = cnt > 0u ? cnt : 1u;
}
__device__ __forceinline__ void xcd_barrier(const XcdBarrier& b) {
    asm volatile("s_waitcnt vmcnt(0)" ::: "memory");
    __syncthreads();
    if (threadIdx.x == 0) {
        unsigned* bar = b.bar;
        __builtin_amdgcn_s_waitcnt(0);
        unsigned nloc = b.st[0], nx = b.st[1];
        if (nloc == 0u) { xcd_barrier_complete(bar, b.x, nloc, nx); b.st[0] = nloc; b.st[1] = nx; }
        const unsigned old = xb_add(&bar[XB_XSUB(b.x)], 1u);
        const unsigned gen = old / nloc;
        if (old + 1u == (gen + 1u) * nloc) {
            __builtin_amdgcn_fence(__ATOMIC_RELEASE, "agent");
            asm volatile("s_waitcnt vmcnt(0)" ::: "memory");
            const unsigned og = xb_add(&bar[XB_TOP], 1u);
            const unsigned tg = og / nx;
            if (og + 1u == (tg + 1u) * nx) xb_add(&bar[XB_TOPGEN], 1u);
            else XB_SPIN(xb_ld(&bar[XB_TOPGEN]) == tg, bar);
            __builtin_amdgcn_fence(__ATOMIC_ACQUIRE, "agent");
            xb_add(&bar[XB_XGEN(b.x)], 1u);
            asm volatile("s_waitcnt vmcnt(0)" ::: "memory");
        } else {
            XB_SPIN(xb_ld(&bar[XB_XGEN(b.x)]) == gen, bar);
            __builtin_amdgcn_fence(__ATOMIC_ACQUIRE, "agent");
            asm volatile("s_waitcnt vmcnt(0)" ::: "memory");
        }
    }
    __syncthreads();
}

__device__ __forceinline__ unsigned f2bf(float f) { unsigned u = __builtin_bit_cast(unsigned, f); return (u + 0x7fffu + ((u >> 16) & 1u)) >> 16; }
__device__ __forceinline__ unsigned pk2(float lo, float hi) { return f2bf(lo) | (f2bf(hi) << 16); }
__device__ __forceinline__ float bf2f(unsigned short b) { return __builtin_bit_cast(float, (unsigned)b << 16); }
__device__ __forceinline__ float bflo(unsigned w) { return __builtin_bit_cast(float, w << 16); }
__device__ __forceinline__ float bfhi(unsigned w) { return __builtin_bit_cast(float, w & 0xffff0000u); }
__device__ __forceinline__ float wave_sum(float v) {
#pragma unroll
    for (int o = 1; o < 64; o <<= 1) v += __shfl_xor(v, o);
    return v;
}
#define LDS_WAIT() asm volatile("s_waitcnt lgkmcnt(0)" ::: "memory")

struct Args { const float* in[20]; float* out; unsigned char* ws; int ph_lo, ph_hi, li, pad; };

struct Frame {
    LAS unsigned char* lds; int tid, lane, wave, G, bid;
    const float* in[20]; float* out; unsigned char* ws;
};

__device__ __forceinline__ void transpose_item(const float* W, int N, int c0, int k0, const float* gsc, bf16_t* WT, int K, int n0, LAS float* scr, int lane) {
#pragma unroll 8
    for (int i = 0; i < 32; ++i) { const int kk = 2 * i + (lane >> 5); const float s = gsc ? gsc[k0 + kk] : 1.0f; scr[kk * 33 + (lane & 31)] = W[(size_t)(k0 + kk) * N + c0 + (lane & 31)] * s; }
    LDS_WAIT(); asm volatile("" ::: "memory");
    const int c = lane & 7;
#pragma unroll
    for (int j = 0; j < 4; ++j) { const int n = (lane >> 3) + 8 * j; const LAS float* s = scr + (8 * c) * 33 + n;
        u32x4 o; o.x = pk2(s[0 * 33], s[1 * 33]); o.y = pk2(s[2 * 33], s[3 * 33]); o.z = pk2(s[4 * 33], s[5 * 33]); o.w = pk2(s[6 * 33], s[7 * 33]);
        *(GAS u32x4*)(WT + (size_t)(n0 + n) * K + k0 + 8 * c) = o; }
    LDS_WAIT(); asm volatile("" ::: "memory");
}
__device__ __forceinline__ void p0_prologue(Frame& F) {
    LAS float* scr = (LAS float*)(F.lds + F.wave * 16384);
    const int gw = F.bid * 8 + F.wave, NGW = F.G * 8;
    const float* g_mix = F.in[5]; const float* g_ffn = F.in[6];
    unsigned char* ws = F.ws;
    constexpr int I1 = 16 * (NCI / 32), I2 = 16 * 32, I3 = 16 * (2 * DFF / 32), I4 = (DFF / 64) * 32, I5 = 16 * (NQKV / 32), I6 = 16 * 32;
    constexpr int NIT = I1 + I2 + 2 * I3 + 2 * I4 + I5 + I6;
    for (int it = gw; it < NIT; it += NGW) {
        int r = it;
        if (r < I1) {
            const int nb = r % (NCI / 32), kb = r / (NCI / 32), n0 = nb * 32, pn = n0 >> 8, w = n0 & 255;
            int c0; if (pn < 8) { const int bj = w >> 7; c0 = (bj ? 2048 : 1024) + pn * 128 + (w & 127); } else c0 = (pn - 8) * 256 + w;
            transpose_item(F.in[8], NCI, c0, kb * 64, g_mix, (bf16_t*)(ws + WS_W1), D, n0, scr, F.lane); continue; } r -= I1;
        if (r < I2) { const int nb = r % 32, kb = r / 32; transpose_item(F.in[10], D, nb * 32, kb * 64, nullptr, (bf16_t*)(ws + WS_W2), D, nb * 32, scr, F.lane); continue; } r -= I2;
        if (r < 2 * I3) { const int l = r / I3; r -= l * I3; const int nb = r % (2 * DFF / 32), kb = r / (2 * DFF / 32), n0 = nb * 32, pn = n0 >> 8, w = n0 & 255, bj = w >> 7;
            transpose_item((bj ? F.in[18] : F.in[17]) + (size_t)l * D * DFF, DFF, pn * 128 + (w & 127), kb * 64, g_ffn + l * D, (bf16_t*)(ws + (l ? WS_W7 : WS_W3)), D, n0, scr, F.lane); continue; } r -= 2 * I3;
        if (r < 2 * I4) { const int l = r / I4; r -= l * I4; const int nb = r % 32, kb = r / 32;
            transpose_item(F.in[19] + (size_t)l * DFF * D, D, nb * 32, kb * 64, nullptr, (bf16_t*)(ws + (l ? WS_W8 : WS_W4)), DFF, nb * 32, scr, F.lane); continue; } r -= 2 * I4;
        if (r < I5) { const int nb = r % (NQKV / 32), kb = r / (NQKV / 32), n0 = nb * 32;
            const float* W; int N, c0; if (n0 < 1024) { W = F.in[11]; N = 1024; c0 = n0; } else if (n0 < 1152) { W = F.in[12]; N = 128; c0 = n0 - 1024; } else { W = F.in[13]; N = 128; c0 = n0 - 1152; }
            transpose_item(W, N, c0, kb * 64, g_mix + D, (bf16_t*)(ws + WS_W5), D, n0, scr, F.lane); continue; } r -= I5;
        { const int nb = r % 32, kb = r / 32; transpose_item(F.in[14], D, nb * 32, kb * 64, nullptr, (bf16_t*)(ws + WS_W6), D, nb * 32, scr, F.lane); }
    }
    bf16_t* XB = (bf16_t*)(ws + WS_XB); float* part = (float*)(ws + WS_PART);
    for (int m = gw; m < M; m += NGW) {
        const float* xrow = (m < SEQ) ? F.in[0] + (size_t)m * D : F.in[1] + (size_t)(m - SEQ) * D;
        const GAS f32x4* xr = (const GAS f32x4*)xrow + F.lane;
        f32x4 v[4]; float s = 0.f;
#pragma unroll
        for (int j = 0; j < 4; ++j) { v[j] = xr[64 * j]; s += (v[j][0] * v[j][0] + v[j][1] * v[j][1]) + (v[j][2] * v[j][2] + v[j][3] * v[j][3]); }
        s = wave_sum(s);
        GAS unsigned long long* o8 = (GAS unsigned long long*)(XB + (size_t)m * D) + F.lane;
#pragma unroll
        for (int j = 0; j < 4; ++j) o8[64 * j] = (unsigned long long)pk2(v[j][0], v[j][1]) | ((unsigned long long)pk2(v[j][2], v[j][3]) << 32);
        if (F.lane < 16) part[(size_t)m * 16 + F.lane] = (F.lane == 0) ? s : 0.f;
    }
    {
        const size_t per = (size_t)124 * 128 / 4;
        const size_t tot = 2 * (size_t)NSEQ * per;
        for (size_t i = (size_t)F.bid * 512 + F.tid; i < tot; i += (size_t)F.G * 512) {
            const int kv = (int)(i / (NSEQ * per)); const size_t rem = i % (NSEQ * per); const int n = (int)(rem / per); const size_t e = rem % per;
            const f32x4 v = *((const f32x4*)(F.in[3 + kv] + (size_t)n * 128 * 128 + 4 * 128) + e);
            *((f32x4*)(F.out + (kv ? O_CVS : O_CKS) + (size_t)n * 128 * 128) + e) = v;
        }
    }
}

__device__ __forceinline__ void unpack8(const u32x4 w, float (&f)[8]) { f[0] = bflo(w.x); f[1] = bfhi(w.x); f[2] = bflo(w.y); f[3] = bfhi(w.y); f[4] = bflo(w.z); f[5] = bfhi(w.z); f[6] = bflo(w.w); f[7] = bfhi(w.w); }
__device__ __forceinline__ void conv_phase(Frame& F) {
    const bf16_t* U = (const bf16_t*)(F.ws + WS_U); bf16_t* BV = (bf16_t*)(F.ws + WS_BQ);
    const float* cw = F.in[9]; const float* st = F.in[2];
    const size_t tot = (size_t)M * 128;
    for (size_t i = (size_t)F.bid * 512 + F.tid; i < tot; i += (size_t)F.G * 512) {
        const int row = (int)(i >> 7), ch = (int)(i & 127) * 8;
        float u0[8], u1[8], u2[8], b[8], w0[8], w1[8], w2[8];
        unpack8(*(const u32x4*)(U + (size_t)row * D + ch), u2);
        unpack8(*(const u32x4*)(BV + (size_t)row * D + ch), b);
        int tpos, n = 0;
        if (row < SEQ) tpos = row; else { n = (row - SEQ) >> 2; tpos = (row - SEQ) & 3; }
#pragma unroll
        for (int j = 0; j < 8; ++j) { u0[j] = 0.f; u1[j] = 0.f; }
        if (tpos >= 1) unpack8(*(const u32x4*)(U + (size_t)(row - 1) * D + ch), u1);
        else if (row >= SEQ) { const float* s = st + ((size_t)n * 2 + 1) * D + ch;
#pragma unroll
            for (int j = 0; j < 8; ++j) u1[j] = s[j]; }
        if (tpos >= 2) unpack8(*(const u32x4*)(U + (size_t)(row - 2) * D + ch), u0);
        else if (row >= SEQ) { const float* s = st + ((size_t)n * 2 + tpos) * D + ch;
#pragma unroll
            for (int j = 0; j < 8; ++j) u0[j] = s[j]; }
#pragma unroll
        for (int j = 0; j < 8; ++j) { w0[j] = cw[ch + j]; w1[j] = cw[D + ch + j]; w2[j] = cw[2 * D + ch + j]; }
        float o[8];
#pragma unroll
        for (int j = 0; j < 8; ++j) o[j] = b[j] * (w0[j] * u0[j] + w1[j] * u1[j] + w2[j] * u2[j]);
        u32x4 w; w.x = pk2(o[0], o[1]); w.y = pk2(o[2], o[3]); w.z = pk2(o[4], o[5]); w.w = pk2(o[6], o[7]);
        *(u32x4*)(BV + (size_t)row * D + ch) = w;
        float* so = nullptr;
        if (row < SEQ) { if (row >= SEQ - 2) so = F.out + O_SCP + (size_t)(row - (SEQ - 2)) * D + ch; }
        else if (tpos >= 2) so = F.out + O_SCS + ((size_t)n * 2 + (tpos - 2)) * D + ch;
        if (so) { *(f32x4*)so = (f32x4){u2[0], u2[1], u2[2], u2[3]}; *(f32x4*)(so + 4) = (f32x4){u2[4], u2[5], u2[6], u2[7]}; }
    }
}

__device__ __forceinline__ void final_norm(Frame& F) {
    const int gw = F.bid * 8 + F.wave, NGW = F.G * 8;
    const float* gf = F.in[7];
    f32x4 g[4];
#pragma unroll
    for (int j = 0; j < 4; ++j) g[j] = *((const f32x4*)gf + F.lane + 64 * j);
    for (int m = gw; m < M; m += NGW) {
        GAS f32x4* xr = (GAS f32x4*)(F.out + (size_t)m * D) + F.lane;
        f32x4 v[4]; float s = 0.f;
#pragma unroll
        for (int j = 0; j < 4; ++j) { v[j] = xr[64 * j]; s += (v[j][0] * v[j][0] + v[j][1] * v[j][1]) + (v[j][2] * v[j][2] + v[j][3] * v[j][3]); }
        s = wave_sum(s);
        const float r = __builtin_amdgcn_rsqf(s * (1.0f / D) + EPS);
#pragma unroll
        for (int j = 0; j < 4; ++j) xr[64 * j] = v[j] * r * g[j];
    }
}

__device__ __forceinline__ int t5_bucket(int n) {
    if (n < 16) return n;
    int l = 16 + (int)(logf((float)n * (1.0f / 16.0f)) / 2.0794415416798357f * 16.0f);
    return l < 31 ? l : 31;
}
__device__ __forceinline__ int crow(int r, int hi) { return (r & 3) + 8 * (r >> 2) + 4 * hi; }
__device__ __forceinline__ s16x4 vtr(const LAS unsigned char* p) { typedef short v4i16_t __attribute__((ext_vector_type(4))); return __builtin_bit_cast(s16x4, __builtin_amdgcn_ds_read_tr16_b64_v4i16((LAS v4i16_t*)p)); }

constexpr int AT_K = 0, AT_V = 32768, AT_B = 65536, AT_WS = 70144, AT_OST = 72192, AT_END = AT_OST + 8 * 4096;
static_assert(AT_END <= 131072, "attention LDS");

__device__ __forceinline__ void attn_prompt_unit(Frame& F, int qb, int kvh) {
    const int tid = F.tid, lane = F.lane, wid = F.wave, r32 = lane & 31, hi = lane >> 5;
    bf16_t* Qb = (bf16_t*)(F.ws + WS_BQ); const bf16_t* Kb = (const bf16_t*)(F.ws + WS_K); const bf16_t* Vb = (const bf16_t*)(F.ws + WS_V);
    LAS unsigned char* lds = F.lds;
    const int krow0 = 128 * qb - 128;
#pragma unroll
    for (int i = 0; i < 4; ++i) { const int key = 64 * i + lane; int gr = krow0 + key; gr = gr < 0 ? 0 : gr;
        const u32x4 v = *(const u32x4*)(Kb + (size_t)gr * 128 + kvh * 64 + wid * 8);
        *(LAS u32x4*)(lds + AT_K + wid * 4096 + key * 16) = v; }
#pragma unroll
    for (int i = 0; i < 4; ++i) { const int p = wid * 4 + i, dh = p >> 4, kg = p & 15, key = 16 * kg + (lane >> 2); int gr = krow0 + key; gr = gr < 0 ? 0 : gr;
        const u32x4 v = *(const u32x4*)(Vb + (size_t)gr * 128 + kvh * 64 + dh * 32 + (lane & 3) * 8);
        *(LAS u32x4*)(lds + AT_V + dh * 16384 + key * 64 + (lane & 3) * 16) = v; }
    for (int idx = tid; idx < 8 * 129; idx += 512) { const int hl = idx / 129, d = idx % 129;
        ((LAS float*)(lds + AT_B))[hl * 132 + d] = F.in[16][t5_bucket(d) * NH + kvh * 8 + hl] * LOG2E; }
    __syncthreads();
    const int h = kvh * 8 + wid;
    const float sink2 = F.in[15][h] * LOG2E;
    const LAS float* bt = (const LAS float*)(lds + AT_B) + wid * 132;
    LAS float* wsf = (LAS float*)(lds + AT_WS) + wid * 64;
    LAS bf16_t* stg = (LAS bf16_t*)(lds + AT_OST) + wid * 2048;
    const int vlane = (4 * hi + ((lane & 15) >> 2)) * 64 + ((lane >> 4) & 1) * 32 + (lane & 3) * 8;
    for (int s = 0; s < 4; ++s) {
        const size_t qrow = (size_t)128 * qb + 32 * s + r32;
        bf16x8 qf[4];
#pragma unroll
        for (int d0 = 0; d0 < 4; ++d0) qf[d0] = *(const bf16x8*)(Qb + qrow * D + h * 64 + d0 * 16 + hi * 8);
        f32x16 S[5];
#pragma unroll
        for (int cb = 0; cb < 5; ++cb) {
            const int c = s + cb;
            const bool blk_ok = (qb > 0) || (c >= 4);
#pragma unroll
            for (int r = 0; r < 16; ++r) {
                const int dist = 128 - 32 * cb + r32 - crow(r, hi);
                const bool ok = blk_ok && dist >= 0 && dist <= 128;
                const int dc = dist < 0 ? 0 : (dist > 128 ? 128 : dist);
                const float bv = bt[dc];
                S[cb][r] = ok ? bv : NEGBIG;
            }
#pragma unroll
            for (int d0 = 0; d0 < 4; ++d0) {
                const bf16x8 kf = *(const LAS bf16x8*)(lds + AT_K + (2 * d0 + hi) * 4096 + (32 * c + r32) * 16);
                S[cb] = __builtin_amdgcn_mfma_f32_32x32x16_bf16(kf, qf[d0], S[cb], 0, 0, 0);
            }
        }
        float mx = sink2;
#pragma unroll
        for (int cb = 0; cb < 5; ++cb)
#pragma unroll
            for (int r = 0; r < 16; ++r) mx = fmaxf(mx, S[cb][r]);
        mx = fmaxf(mx, __shfl_xor(mx, 32));
        float ls = 0.f;
#pragma unroll
        for (int cb = 0; cb < 5; ++cb)
#pragma unroll
            for (int r = 0; r < 16; ++r) { const float p = __builtin_amdgcn_exp2f(S[cb][r] - mx); S[cb][r] = p; ls += p; }
        ls += __shfl_xor(ls, 32);
        ls += __builtin_amdgcn_exp2f(sink2 - mx);
        if (hi == 0) wsf[r32] = ls;
        f32x16 o[2]; o[0] = (f32x16){}; o[1] = (f32x16){};
#pragma unroll
        for (int cb = 0; cb < 5; ++cb) {
            const int c = s + cb;
#pragma unroll
            for (int s2 = 0; s2 < 2; ++s2) {
                u32x4 pw; pw.x = cvt_pk_bf16(S[cb][8 * s2 + 0], S[cb][8 * s2 + 1]); pw.y = cvt_pk_bf16(S[cb][8 * s2 + 2], S[cb][8 * s2 + 3]);
                pw.z = cvt_pk_bf16(S[cb][8 * s2 + 4], S[cb][8 * s2 + 5]); pw.w = cvt_pk_bf16(S[cb][8 * s2 + 6], S[cb][8 * s2 + 7]);
                const bf16x8 pa = __builtin_bit_cast(bf16x8, pw);
#pragma unroll
                for (int dh = 0; dh < 2; ++dh) {
                    const LAS unsigned char* vp = lds + AT_V + dh * 16384 + (32 * c + 16 * s2) * 64 + vlane;
                    const s16x4 lo = vtr(vp), hi4 = vtr(vp + 512);
                    const bf16x8 vf = (bf16x8){lo[0], lo[1], lo[2], lo[3], hi4[0], hi4[1], hi4[2], hi4[3]};
                    o[dh] = __builtin_amdgcn_mfma_f32_32x32x16_bf16(pa, vf, o[dh], 0, 0, 0);
                }
            }
        }
        LDS_WAIT();
#pragma unroll
        for (int r = 0; r < 16; ++r) { const int q = crow(r, hi); const float rl = __builtin_amdgcn_rcpf(wsf[q]);
            stg[q * 64 + r32] = (bf16_t)f2bf(o[0][r] * rl); stg[q * 64 + 32 + r32] = (bf16_t)f2bf(o[1][r] * rl); }
        LDS_WAIT(); asm volatile("" ::: "memory");
#pragma unroll
        for (int i = 0; i < 4; ++i) { const int row = i * 8 + (lane >> 3), ch = lane & 7; const u32x4 v = *(const LAS u32x4*)(stg + row * 64 + ch * 8);
            *(u32x4*)(Qb + ((size_t)128 * qb + 32 * s + row) * D + h * 64 + ch * 8) = v; }
        LDS_WAIT(); asm volatile("" ::: "memory");
    }
    __syncthreads();
}

constexpr int AS_Q = 0, AS_S = 2048, AS_WAVE = 2048 + 8 * 136 * 4;
static_assert(AS_WAVE * 8 <= 131072, "sample attention LDS");
__device__ __forceinline__ void attn_sample_unit(Frame& F, int n, int kvh, int t) {
    const int lane = F.lane;
    LAS float* ql = (LAS float*)(F.lds + F.wave * AS_WAVE + AS_Q);
    LAS float* sl = (LAS float*)(F.lds + F.wave * AS_WAVE + AS_S);
    bf16_t* Qb = (bf16_t*)(F.ws + WS_BQ); const bf16_t* Kb = (const bf16_t*)(F.ws + WS_K); const bf16_t* Vb = (const bf16_t*)(F.ws + WS_V);
    const float* ck = F.in[3] + (size_t)n * 128 * 128 + kvh * 64; const float* cv = F.in[4] + (size_t)n * 128 * 128 + kvh * 64;
    const size_t row0 = (size_t)SEQ + 4 * n;
#pragma unroll
    for (int i = 0; i < 8; ++i) ql[i * 64 + lane] = bf2f(Qb[(row0 + t) * D + (kvh * 8 + i) * 64 + lane]);
    LDS_WAIT(); asm volatile("" ::: "memory");
#pragma unroll 1
    for (int pass = 0; pass < 3; ++pass) {
        const int j = pass * 64 + lane;
        if (j < 132) {
            float k[64];
            if (j < 128) {
#pragma unroll
                for (int d4 = 0; d4 < 16; ++d4) { const f32x4 v = *(const f32x4*)(ck + (size_t)j * 128 + d4 * 4); k[4 * d4] = v[0]; k[4 * d4 + 1] = v[1]; k[4 * d4 + 2] = v[2]; k[4 * d4 + 3] = v[3]; }
            } else {
#pragma unroll
                for (int d8 = 0; d8 < 8; ++d8) { const u32x4 v = *(const u32x4*)(Kb + (row0 + (j - 128)) * 128 + kvh * 64 + d8 * 8); float f[8]; unpack8(v, f);
#pragma unroll
                    for (int e = 0; e < 8; ++e) k[8 * d8 + e] = f[e]; }
            }
            const int dist = t + 128 - j;
            const bool ok = dist >= 0 && dist <= 128;
            const int bk = t5_bucket(ok ? dist : 0);
#pragma unroll
            for (int i = 0; i < 8; ++i) {
                float a = 0.f;
#pragma unroll
                for (int d4 = 0; d4 < 16; ++d4) { const f32x4 q = *(const LAS f32x4*)(ql + i * 64 + d4 * 4); a += k[4 * d4] * q[0] + k[4 * d4 + 1] * q[1] + k[4 * d4 + 2] * q[2] + k[4 * d4 + 3] * q[3]; }
                sl[i * 136 + j] = ok ? a + F.in[16][bk * NH + kvh * 8 + i] * LOG2E : NEGBIG;
            }
        }
    }
    LDS_WAIT(); asm volatile("" ::: "memory");
    {
        const int i = lane >> 3, sub = lane & 7;
        const float sink2 = F.in[15][kvh * 8 + i] * LOG2E;
        float mx = sink2;
        for (int e = 0; e < 17; ++e) { const int j = sub * 17 + e; if (j < 132) mx = fmaxf(mx, sl[i * 136 + j]); }
        mx = fmaxf(mx, __shfl_xor(mx, 1)); mx = fmaxf(mx, __shfl_xor(mx, 2)); mx = fmaxf(mx, __shfl_xor(mx, 4));
        float ls = 0.f;
        for (int e = 0; e < 17; ++e) { const int j = sub * 17 + e; if (j < 132) { const float p = __builtin_amdgcn_exp2f(sl[i * 136 + j] - mx); sl[i * 136 + j] = p; ls += p; } }
        ls += __shfl_xor(ls, 1); ls += __shfl_xor(ls, 2); ls += __shfl_xor(ls, 4);
        ls += __builtin_amdgcn_exp2f(sink2 - mx);
        const float rl = 1.0f / ls;
        for (int e = 0; e < 17; ++e) { const int j = sub * 17 + e; if (j < 132) sl[i * 136 + j] *= rl; }
    }
    LDS_WAIT(); asm volatile("" ::: "memory");
    float o[8];
#pragma unroll
    for (int i = 0; i < 8; ++i) o[i] = 0.f;
#pragma unroll 4
    for (int j = t; j < 128; ++j) { const float v = cv[(size_t)j * 128 + lane];
#pragma unroll
        for (int i = 0; i < 8; ++i) o[i] += sl[i * 136 + j] * v; }
    for (int j = 128; j <= 128 + t; ++j) { const float v = bf2f(Vb[(row0 + (j - 128)) * 128 + kvh * 64 + lane]);
#pragma unroll
        for (int i = 0; i < 8; ++i) o[i] += sl[i * 136 + j] * v; }
#pragma unroll
    for (int i = 0; i < 8; ++i) Qb[(row0 + t) * D + (kvh * 8 + i) * 64 + lane] = (bf16_t)f2bf(o[i]);
    LDS_WAIT(); asm volatile("" ::: "memory");
}

__device__ __forceinline__ void attn_phase(Frame& F) {
    for (int u = F.bid; u < 256; u += F.G) attn_prompt_unit(F, u >> 1, u & 1);
    __syncthreads();
    const int gw = F.bid * 8 + F.wave, NGW = F.G * 8;
    for (int u = gw; u < NSEQ * 2 * 4; u += NGW) attn_sample_unit(F, u >> 3, (u >> 2) & 1, u & 3);
    __syncthreads();
}

constexpr int RING_BYTES = 131072, MISC_OFF = RING_BYTES + 320, LDS_BYTES = 147456;
constexpr int N_PHASES = 12;

__global__ void __launch_bounds__(512, 2) fwd_kernel(Args args) {
    extern __shared__ __attribute__((aligned(16))) unsigned char lds_raw[];
    Frame F;
    F.lds = (LAS unsigned char*)lds_raw;
    F.tid = threadIdx.x; F.lane = F.tid & 63; F.wave = __builtin_amdgcn_readfirstlane(F.tid >> 6);
    F.G = gridDim.x; F.bid = blockIdx.x;
#pragma unroll
    for (int i = 0; i < 20; ++i) F.in[i] = args.in[i];
    F.out = args.out; F.ws = args.ws;
    volatile LAS unsigned* MISC = (volatile LAS unsigned*)(F.lds + MISC_OFF);
    for (int u = F.tid; u < (LDS_BYTES - RING_BYTES) / 4; u += 512) ((LAS unsigned*)(F.lds + RING_BYTES))[u] = 0u;
    __syncthreads();
    unsigned* ctl = (unsigned*)(F.ws + WS_CTL);
    XcdBarrier bar; bar.bar = ctl + 1024 + args.li * XCD_BAR_WORDS; bar.x = 0; bar.st = nullptr;
    const int lo = args.ph_lo, hi = args.ph_hi;
    if (hi - lo > 1) bar = xcd_barrier_post(ctl + 1024 + args.li * XCD_BAR_WORDS, MISC + 8);
#define IN(k) (lo <= (k) && (k) < hi)
#define SEAM(k) do { if (IN(k) && IN((k) + 1)) xcd_barrier(bar); } while (0)

    unsigned char* ws = F.ws;
    bf16_t* XB = (bf16_t*)(ws + WS_XB); bf16_t* Ub = (bf16_t*)(ws + WS_U); bf16_t* BQ = (bf16_t*)(ws + WS_BQ);
    bf16_t* Kb = (bf16_t*)(ws + WS_K); bf16_t* Vb = (bf16_t*)(ws + WS_V); bf16_t* Ab = (bf16_t*)(ws + WS_A);
    float* part = (float*)(ws + WS_PART);
    float* xres = F.out + O_Y;

    if (IN(0)) { p0_prologue(F); } SEAM(0);
    if (IN(1)) { pg8::Gemm g{XB, (const bf16_t*)(ws + WS_W1), M, NCI, D}; pg8::StaticOrder S; S.init(M, NCI, F.G, F.bid);
        EpiConvIn E{part, Ub, BQ}; pg8::gemm_phase<EpiConvIn, pg8::StaticOrder>(F.lds, g, S, E); } SEAM(1);
    if (IN(2)) { conv_phase(F); } SEAM(2);
    if (IN(3)) { pg8::Gemm g{BQ, (const bf16_t*)(ws + WS_W2), M, D, D}; pg8::StaticOrder S; S.init(M, D, F.G, F.bid);
        EpiResid E{F.in[0], F.in[1] - (size_t)SEQ * D, xres, XB, part + PART_STRIDE}; pg8::gemm_phase<EpiResid, pg8::StaticOrder>(F.lds, g, S, E); } SEAM(3);
    if (IN(4)) { pg8::Gemm g{XB, (const bf16_t*)(ws + WS_W3), M, 2 * DFF, D}; pg8::StaticOrder S; S.init(M, 2 * DFF, F.G, F.bid);
        EpiSwiglu E{part + PART_STRIDE, Ab}; pg8::gemm_phase<EpiSwiglu, pg8::StaticOrder>(F.lds, g, S, E); } SEAM(4);
    if (IN(5)) { pg8::Gemm g{Ab, (const bf16_t*)(ws + WS_W4), M, D, DFF}; pg8::StaticOrder S; S.init(M, D, F.G, F.bid);
        EpiResid E{xres, xres, xres, XB, part + 2 * PART_STRIDE}; pg8::gemm_phase<EpiResid, pg8::StaticOrder>(F.lds, g, S, E); } SEAM(5);
    if (IN(6)) { pg8::Gemm g{XB, (const bf16_t*)(ws + WS_W5), M, NQKV, D}; pg8::StaticOrder S; S.init(M, NQKV, F.G, F.bid);
        EpiQKV E{part + 2 * PART_STRIDE, BQ, Kb, Vb, F.out}; pg8::gemm_phase<EpiQKV, pg8::StaticOrder>(F.lds, g, S, E); } SEAM(6);
    if (IN(7)) { attn_phase(F); } SEAM(7);
    if (IN(8)) { pg8::Gemm g{BQ, (const bf16_t*)(ws + WS_W6), M, D, D}; pg8::StaticOrder S; S.init(M, D, F.G, F.bid);
        EpiResid E{xres, xres, xres, XB, part + 3 * PART_STRIDE}; pg8::gemm_phase<EpiResid, pg8::StaticOrder>(F.lds, g, S, E); } SEAM(8);
    if (IN(9)) { pg8::Gemm g{XB, (const bf16_t*)(ws + WS_W7), M, 2 * DFF, D}; pg8::StaticOrder S; S.init(M, 2 * DFF, F.G, F.bid);
        EpiSwiglu E{part + 3 * PART_STRIDE, Ab}; pg8::gemm_phase<EpiSwiglu, pg8::StaticOrder>(F.lds, g, S, E); } SEAM(9);
    if (IN(10)) { pg8::Gemm g{Ab, (const bf16_t*)(ws + WS_W8), M, D, DFF}; pg8::StaticOrder S; S.init(M, D, F.G, F.bid);
        EpiResid E{xres, xres, xres, XB, part + 4 * PART_STRIDE}; pg8::gemm_phase<EpiResid, pg8::StaticOrder>(F.lds, g, S, E); } SEAM(10);
    if (IN(11)) { final_norm(F); }
#undef IN
#undef SEAM
}

extern "C" void kernel_launch(void* const* d_in, const int* in_sizes, int n_in, void* d_out, int out_size, void* d_ws, size_t ws_size, hipStream_t stream) {
    static int grid = 0;
    if (grid == 0) {
        if (n_in != 20 || ws_size < WS_END) { fprintf(stderr, "kernel_launch: unexpected n_in %d / ws_size %zu\n", n_in, ws_size); grid = -1; return; }
        int dev = 0, cus = 0, per_cu = 0;
        if (hipGetDevice(&dev) != hipSuccess || hipDeviceGetAttribute(&cus, hipDeviceAttributeMultiprocessorCount, dev) != hipSuccess) { grid = -1; return; }
        if (hipFuncSetAttribute((const void*)fwd_kernel, hipFuncAttributeMaxDynamicSharedMemorySize, LDS_BYTES) != hipSuccess) { fprintf(stderr, "kernel_launch: hipFuncSetAttribute failed\n"); grid = -1; return; }
        if (hipOccupancyMaxActiveBlocksPerMultiprocessor(&per_cu, (const void*)fwd_kernel, 512, LDS_BYTES) != hipSuccess || per_cu < 1) { fprintf(stderr, "kernel_launch: occupancy query says %d blocks per CU\n", per_cu); per_cu = 1; }
        (void)hipGetLastError();
        grid = cus;
    }
    if (grid < 0) return;
    (void)hipMemsetAsync((char*)d_ws + WS_CTL, 0, CTL_ZERO_BYTES, stream);
    Args a{};
    for (int i = 0; i < 20; ++i) a.in[i] = (const float*)d_in[i];
    a.out = (float*)d_out; a.ws = (unsigned char*)d_ws;
#if MK_N_LAUNCHES == 1
    a.ph_lo = 0; a.ph_hi = N_PHASES; a.li = 0;
    hipLaunchKernelGGL(fwd_kernel, dim3(grid), dim3(512), LDS_BYTES, stream, a);
#else
    for (int p = 0; p < N_PHASES; ++p) { a.ph_lo = p; a.ph_hi = p + 1; a.li = 0; hipLaunchKernelGGL(fwd_kernel, dim3(grid), dim3(512), LDS_BYTES, stream, a); }
#endif
}
```
